# Optimizing an MI355X kernel written in HIP

```python
import jax, jax.numpy as jnp
from jax import lax
import numpy as np

D_MODEL = 1024
BATCH = 4
SEQ = 8192
DEPTH = 1

ATT_HEADS = 8
ATT_KV_HEADS = 2
ATT_HEAD_DIM = 64
WINDOW = 128
ATT_BLOCK = 128
RET_HEADS = 4
RET_QK_DIM = 64
RET_V_DIM = 128
RET_CHUNK = 128
ROT_BASE = 10000.0

ATT_WIDTH = ATT_HEADS * ATT_HEAD_DIM
ATT_KV_WIDTH = ATT_KV_HEADS * ATT_HEAD_DIM
RET_QK_WIDTH = RET_HEADS * RET_QK_DIM
RET_WIDTH = RET_HEADS * RET_V_DIM
MIX_WIDTH = ATT_WIDTH + RET_WIDTH
IN_SPLITS = (ATT_WIDTH, ATT_KV_WIDTH, ATT_KV_WIDTH, ATT_WIDTH,
             RET_QK_WIDTH, RET_QK_WIDTH, RET_WIDTH, RET_WIDTH)
IN_WIDTH = sum(IN_SPLITS)
RMS_EPS = 1e-6
GN_EPS = 1e-6
NEG_INF = -1e30

kernel_name = "hymba_swa_sink_retention_hybrid"


def rmsnorm(x, g):
    xf = x.astype(jnp.float32)
    y = xf * lax.rsqrt(jnp.mean(xf * xf, axis=-1, keepdims=True) + RMS_EPS)
    return (y * g.astype(jnp.float32)).astype(x.dtype)


def sliding_window_attention(q, k, v, sinks):
    B, S = q.shape[0], q.shape[1]
    N = S // ATT_BLOCK
    G = ATT_HEADS // ATT_KV_HEADS
    q = q.reshape(B, N, ATT_BLOCK, ATT_KV_HEADS, G, ATT_HEAD_DIM)
    k = k.reshape(B, N, ATT_BLOCK, ATT_KV_HEADS, ATT_HEAD_DIM)
    v = v.reshape(B, N, ATT_BLOCK, ATT_KV_HEADS, ATT_HEAD_DIM)

    def with_prev(t):
        prev = jnp.concatenate([jnp.zeros_like(t[:, :1]), t[:, :-1]], axis=1)
        return jnp.concatenate([prev, t], axis=2)

    kk, vv = with_prev(k), with_prev(v)
    scale = ATT_HEAD_DIM ** -0.5
    s = jnp.einsum('bnqhgd,bnkhd->bnhgqk', q, kk).astype(jnp.float32) * scale
    qi = jnp.arange(ATT_BLOCK)[:, None]
    kj = jnp.arange(2 * ATT_BLOCK)[None, :]
    diff = qi + ATT_BLOCK - kj
    band = (diff >= 0) & (diff < WINDOW)
    in_cur = kj >= ATT_BLOCK
    blk = jnp.arange(N)[:, None, None]
    valid = band[None] & ((blk > 0) | in_cur[None])
    s = jnp.where(valid[None, :, None, None], s, NEG_INF)
    sink = jnp.broadcast_to(
        sinks.astype(jnp.float32).reshape(ATT_KV_HEADS, G)[None, None, :, :, None, None],
        s.shape[:-1] + (1,))
    p = jax.nn.softmax(jnp.concatenate([s, sink], axis=-1), axis=-1)[..., :-1]
    o = jnp.einsum('bnhgqk,bnkhd->bnqhgd', p.astype(v.dtype), vv)
    return o.reshape(B, S, ATT_WIDTH)


def rotate_pairs(t, cos, sin):
    B, S, H, D = t.shape
    tf = t.astype(jnp.float32).reshape(B, S, H, D // 2, 2)
    a, b = tf[..., 0], tf[..., 1]
    c, s = cos[None, :, None, :], sin[None, :, None, :]
    out = jnp.stack([a * c - b * s, a * s + b * c], axis=-1)
    return out.reshape(B, S, H, D).astype(t.dtype)


def retention(q, k, v, gn_gain):
    B, S = q.shape[0], q.shape[1]
    C = RET_CHUNK
    N = S // C
    pos = jnp.arange(S, dtype=jnp.float32)
    theta = 1.0 / (ROT_BASE ** jnp.linspace(0.0, 1.0, RET_QK_DIM // 2, dtype=jnp.float32))
    ang = pos[:, None] * theta[None, :]
    cos, sin = jnp.cos(ang), jnp.sin(ang)
    q = rotate_pairs(q, cos, sin)
    k = rotate_pairs(k, cos, sin) * (RET_QK_DIM ** -0.5)

    log_gamma = jnp.log(1.0 - 2.0 ** (-5.0 - jnp.arange(RET_HEADS, dtype=jnp.float32)))
    idx = jnp.arange(C, dtype=jnp.float32)
    rel = idx[:, None] - idx[None, :]
    decay_in = jnp.where(rel >= 0, jnp.exp(log_gamma[:, None, None] * jnp.maximum(rel, 0.0)), 0.0)
    k_dec = jnp.exp(log_gamma[:, None] * (C - 1 - idx)[None, :])
    q_dec = jnp.exp(log_gamma[:, None] * (idx + 1)[None, :])
    chunk_decay = jnp.exp(log_gamma * C)

    q = q.reshape(B, N, C, RET_HEADS, RET_QK_DIM)
    k = k.reshape(B, N, C, RET_HEADS, RET_QK_DIM)
    v = v.reshape(B, N, C, RET_HEADS, RET_V_DIM)

    sc = jnp.einsum('bnchd,bnmhd->bnhcm', q, k) * decay_in[None, None]
    o_inner = jnp.einsum('bnhcm,bnmhe->bnche', sc, v)
    kv_chunk = jnp.einsum('bnmhd,bnmhe,hm->bnhde', k, v, k_dec).astype(jnp.float32)

    def step(state, kv):
        return state * chunk_decay[None, :, None, None] + kv, state

    init = jnp.zeros((B, RET_HEADS, RET_QK_DIM, RET_V_DIM), jnp.float32)
    _, prev = lax.scan(step, init, jnp.moveaxis(kv_chunk, 1, 0))
    prev = jnp.moveaxis(prev, 0, 1)
    o_cross = jnp.einsum('bnchd,bnhde,hc->bnche', q, prev, q_dec)
    o = (o_inner + o_cross).astype(jnp.float32).reshape(B, S, RET_HEADS, RET_V_DIM)

    mu = jnp.mean(o, axis=-1, keepdims=True)
    var = jnp.mean(jnp.square(o - mu), axis=-1, keepdims=True)
    o = (o - mu) * lax.rsqrt(var + GN_EPS)
    o = o.reshape(B, S, RET_WIDTH) * gn_gain.astype(jnp.float32)
    return o.astype(v.dtype)


def setup_inputs(seed: int = 0) -> dict:
    key = jax.random.key(seed)
    ks = jax.random.split(key, 8)
    x = jax.random.normal(ks[0], (BATCH, SEQ, D_MODEL), jnp.float32)
    norm_g = 1.0 + 0.02 * jax.random.normal(ks[1], (DEPTH, D_MODEL), jnp.float32)
    w_in = jax.random.normal(ks[2], (DEPTH, D_MODEL, IN_WIDTH), jnp.float32) * D_MODEL ** -0.5
    att_sinks = 0.5 * jax.random.normal(ks[3], (DEPTH, ATT_HEADS), jnp.float32)
    ret_gn_g = 1.0 + 0.02 * jax.random.normal(ks[4], (DEPTH, RET_WIDTH), jnp.float32)
    w_out = jax.random.normal(ks[5], (DEPTH, MIX_WIDTH, D_MODEL), jnp.float32) * MIX_WIDTH ** -0.5
    final_g = 1.0 + 0.02 * jax.random.normal(ks[6], (D_MODEL,), jnp.float32)
    return {"x": x, "norm_g": norm_g, "w_in": w_in, "att_sinks": att_sinks,
            "ret_gn_g": ret_gn_g, "w_out": w_out, "final_g": final_g}


def reference(x, norm_g, w_in, att_sinks, ret_gn_g, w_out, final_g):
    B, S = x.shape[0], x.shape[1]
    cuts = np.cumsum(IN_SPLITS)[:-1].tolist()
    for l in range(DEPTH):
        h = rmsnorm(x, norm_g[l])
        proj = jnp.einsum('bsd,de->bse', h, w_in[l])
        aq, ak, av, az, rq, rk, rv, rz = jnp.split(proj, cuts, axis=-1)
        a = sliding_window_attention(
            aq.reshape(B, S, ATT_HEADS, ATT_HEAD_DIM),
            ak.reshape(B, S, ATT_KV_HEADS, ATT_HEAD_DIM),
            av.reshape(B, S, ATT_KV_HEADS, ATT_HEAD_DIM),
            att_sinks[l]) * jax.nn.silu(az)
        r = retention(
            rq.reshape(B, S, RET_HEADS, RET_QK_DIM),
            rk.reshape(B, S, RET_HEADS, RET_QK_DIM),
            rv.reshape(B, S, RET_HEADS, RET_V_DIM),
            ret_gn_g[l]) * jax.nn.silu(rz)
        mix = jnp.concatenate([a, r], axis=-1)
        x = x + jnp.einsum('bse,ed->bsd', mix, w_out[l])
    return rmsnorm(x, final_g)
```

```cpp
#include <hip/hip_runtime.h>
#include <hip/hip_cooperative_groups.h>
#include <cstdio>
#include <cstdint>
namespace cg = cooperative_groups;
namespace pg8 {
#define PG8_LAS __attribute__((address_space(3)))
typedef unsigned short bf16_t;
typedef short bf16x8 __attribute__((ext_vector_type(8)));
typedef float f32x4 __attribute__((ext_vector_type(4)));
typedef unsigned u32x4 __attribute__((ext_vector_type(4)));
constexpr int BM = 256, BK = 64, HALF = 128, HTB = HALF * BK * 2  , STAGE_BYTES = 8 * HTB, NXCD = 8, WGM = 8;

__host__ __device__ __forceinline__ int lds_byte(int r, int c) { const int st = (r >> 4) * 2 + (c >> 5), rr = r & 15, cc = c & 31, ob = rr * 64 + cc * 2; return st * 1024 + (ob ^ (((ob >> 9) & 1) << 5)); }
__host__ __device__ __forceinline__ void stage_rc(int b, int& R, int& C) { const int st = b / 1024, sb = b % 1024, swz = sb ^ (((sb >> 9) & 1) << 5); R = (st >> 1) * 16 + swz / 64; C = (st & 1) * 32 + (swz % 64) / 2; }
__host__ __device__ __forceinline__ int perm32(int rho) { const int n = rho >> 4, i = rho & 15; return 8 * (i >> 2) + 4 * n + (i & 3); }

struct Unit { int pm, pn; };
struct Gemm { const bf16_t* A; const bf16_t* Bt; int M, N, K; };

struct StaticOrder {
    int nM, nN, nwg, G, c;
    __host__ __device__ void init(int M, int N, int G_, int c_) { nM = M / BM; nN = N / BM; nwg = nM * nN; G = G_; c = c_; }
    __host__ __device__ bool next(int i, Unit& u) const {
        const long L = (long)i * G + c; if (L >= nwg) return false;
        int wgid = (int)L; { const int q = nwg / NXCD, r = nwg % NXCD, xcd = wgid % NXCD, off = wgid / NXCD; wgid = (xcd < r ? xcd * (q + 1) : r * (q + 1) + (xcd - r) * q) + off; }
        const int nig = WGM * nN, gid = wgid / nig, fm = gid * WGM, gsz = (nM - fm) < WGM ? (nM - fm) : WGM;
        u.pm = fm + ((wgid % nig) % gsz); u.pn = (wgid % nig) / gsz; return true;
    }
    __device__ __forceinline__ void a_ready(const Unit&) const {}
    __device__ __forceinline__ void done(const Unit&) const {}
};

__device__ __forceinline__ unsigned cvt_pk_bf16(float lo, float hi) { unsigned r; asm volatile("v_cvt_pk_bf16_f32 %0, %1, %2" : "=v"(r) : "v"(lo), "v"(hi)); return r; }
typedef float f32x2 __attribute__((ext_vector_type(2)));
__device__ __forceinline__ f32x2 gelu_pk(f32x2 v) {
    const f32x2 av = __builtin_elementwise_abs(v), d = av * 0.2316418882f + 1.0f;
    f32x2 t; t.x = __builtin_amdgcn_rcpf(d.x); t.y = __builtin_amdgcn_rcpf(d.y);
    f32x2 q = t * 0.5307027145f + (-0.7265760135f); q = q * t + 0.7107068705f; q = q * t + (-0.142248368f); q = q * t + 0.127414796f; q = q * t;
    const f32x2 s = (v * v) * (-0.72134752044f);
    f32x2 e; e.x = __builtin_amdgcn_exp2f(s.x); e.y = __builtin_amdgcn_exp2f(s.y);
    const f32x2 m = v * (q * e), r = v - m;
    f32x2 o; o.x = v.x < 0.f ? m.x : r.x; o.y = v.y < 0.f ? m.y : r.y; return o;
}

template <int ACT  > struct EpiBf16 {
    static constexpr bool PERM = true, AFTER_DRAIN = false; static_assert(ACT == 0 || ACT == 1, "EpiBf16: ACT is 0 (none) or 1 (gelu_pk)");
    bf16_t* O; int ldc; const float* bias; int split_cols; size_t split_stride; float scale0;
    __device__ __forceinline__ void operator()(const f32x4 (&acc)[2][2][4][2], const Unit& u, int wr, int wc, int fr, int fq) const {
        const int row0 = u.pm * BM + wr * 64 + fr; int colt = u.pn * BM; bf16_t* base = O;
        float sc = 1.f; if (split_cols) { const int t = colt / split_cols; base += (size_t)t * split_stride; colt -= t * split_cols; if (t == 0) sc = scale0; }
        const int col0 = colt + wc * 32 + 8 * fq, bcol0 = u.pn * BM + wc * 32 + 8 * fq;
        f32x4 bv[2][2];
#pragma unroll
        for (int bj = 0; bj < 2; ++bj)
#pragma unroll
            for (int n = 0; n < 2; ++n) bv[bj][n] = bias ? *(const f32x4*)(bias + bcol0 + bj * HALF + 4 * n) : (f32x4){0.f, 0.f, 0.f, 0.f};
#pragma unroll
        for (int ai = 0; ai < 2; ++ai)
#pragma unroll
            for (int m = 0; m < 4; ++m) { bf16_t* rowp = base + (size_t)(row0 + ai * HALF + m * 16) * ldc + col0;
#pragma unroll
                for (int bj = 0; bj < 2; ++bj) { f32x4 v0 = acc[ai][bj][m][0] + bv[bj][0], v1 = acc[ai][bj][m][1] + bv[bj][1];
                    if (ACT == 1) { f32x2 a = gelu_pk((f32x2){v0[0], v0[1]}), b = gelu_pk((f32x2){v0[2], v0[3]}), c = gelu_pk((f32x2){v1[0], v1[1]}), d = gelu_pk((f32x2){v1[2], v1[3]});
                        v0 = (f32x4){a.x, a.y, b.x, b.y}; v1 = (f32x4){c.x, c.y, d.x, d.y}; }
                    v0 = v0 * sc; v1 = v1 * sc; u32x4 w; w.x = cvt_pk_bf16(v0[0], v0[1]); w.y = cvt_pk_bf16(v0[2], v0[3]); w.z = cvt_pk_bf16(v1[0], v1[1]); w.w = cvt_pk_bf16(v1[2], v1[3]);
                    *(u32x4*)(rowp + bj * HALF) = w; } }
    }
};

struct EpiResid {
    static constexpr bool PERM = false, AFTER_DRAIN = false;
    const float* base; float* out; float* rs; int ldc;
    __device__ __forceinline__ void operator()(const f32x4 (&acc)[2][2][4][2], const Unit& u, int wr, int wc, int fr, int fq) const {
        const int col0 = u.pn * BM + wc * 32 + 4 * fq;
#pragma unroll
        for (int ai = 0; ai < 2; ++ai)
#pragma unroll
            for (int m = 0; m < 4; ++m) {
                const int row = u.pm * BM + ai * HALF + wr * 64 + m * 16 + fr; const size_t off = (size_t)row * ldc + col0; float ss = 0.f;
#pragma unroll
                for (int bj = 0; bj < 2; ++bj)
#pragma unroll
                    for (int n = 0; n < 2; ++n) { const f32x4 bs = *(const f32x4*)(base + off + bj * HALF + n * 16); const f32x4 o = bs + acc[ai][bj][m][n];
                        ss += (o[0] * o[0] + o[1] * o[1]) + (o[2] * o[2] + o[3] * o[3]); *(f32x4*)(out + off + bj * HALF + n * 16) = o; }
                ss += __shfl_xor(ss, 16); ss += __shfl_xor(ss, 32);
                if (fq == 0) rs[(size_t)row * 16 + u.pn * 4 + wc] = ss;
            }
    }
};
template <class Epi, class Sched, bool ALIGN_EPI = false, bool SP2 = false>
__device__ __forceinline__ void gemm_phase(PG8_LAS unsigned char* lds, const Gemm g, const Sched& S, const Epi& E) {
    const int tid = threadIdx.x, wid = __builtin_amdgcn_readfirstlane(tid >> 6), lane = tid & 63, wr = wid >> 2, wc = wid & 3, fr = lane & 15, fq = lane >> 4;
    const int K = g.K, nt = K / BK;
    unsigned voffA[2], voffB[2];
#pragma unroll
    for (int i = 0; i < 2; ++i) { int R, C; stage_rc(tid * 16 + i * 8192, R, C); const int Rb = Epi::PERM ? ((R & ~31) + perm32(R & 31)) : R;
        voffA[i] = (unsigned)(R * K + C) * 2u; voffB[i] = (unsigned)(Rb * K + C) * 2u; }
    const size_t kstep = (size_t)(BK * 2);
    const size_t hstep = (size_t)HALF * K * 2;
    const size_t tstep = 2 * hstep;
    const unsigned ldsw = (unsigned)wid * 1024u;
    const int aoff = lds_byte(wr * 64 + fr, fq * 8), boff = lds_byte(wc * 32 + fr, fq * 8);
#define PG8_SA(b, h) (((b) * 2 + (h)) * HTB)
#define PG8_SB(b, h) ((4 + (b) * 2 + (h)) * HTB)
#define PG8_STAGE(bufoff, gbase, voff) do { _Pragma("unroll") for (int _i = 0; _i < 2; ++_i) \
        __builtin_amdgcn_global_load_lds((const unsigned*)((const char*)(gbase) + (voff)[_i]), (PG8_LAS unsigned*)(lds + (bufoff) + ldsw + _i * 8192), 16, 0, 0); } while (0)
#define PG8_LDA(dst, b, h) do { _Pragma("unroll") for (int m = 0; m < 4; ++m) _Pragma("unroll") for (int k = 0; k < 2; ++k) dst[m][k] = *(const PG8_LAS bf16x8*)(lds + PG8_SA(b, h) + aoff + m * 2048 + k * 1024); } while (0)
#define PG8_LDB(dst, b, h) do { _Pragma("unroll") for (int n = 0; n < 2; ++n) _Pragma("unroll") for (int k = 0; k < 2; ++k) dst[n][k] = *(const PG8_LAS bf16x8*)(lds + PG8_SB(b, h) + boff + n * 2048 + k * 1024); } while (0)
#define PG8_MMA(ai, bj, At, Bt) do { __builtin_amdgcn_s_setprio(1); _Pragma("unroll") for (int m = 0; m < 4; ++m) _Pragma("unroll") for (int n = 0; n < 2; ++n) _Pragma("unroll") for (int k = 0; k < 2; ++k) \
        acc[ai][bj][m][n] = __builtin_amdgcn_mfma_f32_16x16x32_bf16(Bt[n][k], At[m][k], acc[ai][bj][m][n], 0, 0, 0); __builtin_amdgcn_s_setprio(0); } while (0)
#define PG8_WAIT_V(n) asm volatile("s_waitcnt vmcnt(" #n ")" ::: "memory")
#define PG8_WAIT_L(n) asm volatile("s_waitcnt lgkmcnt(" #n ")" ::: "memory")
#define PG8_BAR __builtin_amdgcn_s_barrier()
#define PG8_SCHED __builtin_amdgcn_sched_barrier(0)
    Unit cur, nxt; int ui = 0;
    if (!S.next(0, cur)) return;
    f32x4 acc[2][2][4][2];
#pragma unroll
    for (int a = 0; a < 2; ++a)
#pragma unroll
        for (int b = 0; b < 2; ++b)
#pragma unroll
            for (int m = 0; m < 4; ++m)
#pragma unroll
                for (int n = 0; n < 2; ++n) acc[a][b][m][n] = (f32x4){0.f, 0.f, 0.f, 0.f};
    bf16x8 At[4][2], B0[2][2], B1[2][2];
    const char* cA = (const char*)g.A + (size_t)cur.pm * tstep; const char* cB = (const char*)g.Bt + (size_t)cur.pn * tstep;
    S.a_ready(cur);
    if constexpr (SP2) {
        PG8_STAGE(PG8_SB(0, 0), cB, voffB); PG8_STAGE(PG8_SB(0, 1), cB + hstep, voffB); PG8_STAGE(PG8_SA(0, 0), cA, voffA); PG8_STAGE(PG8_SA(0, 1), cA + hstep, voffA);
        if (wr == 1) PG8_BAR;
        PG8_WAIT_V(2); PG8_BAR;
        PG8_STAGE(PG8_SB(1, 0), cB + kstep, voffB); PG8_STAGE(PG8_SA(1, 0), cA + kstep, voffA); PG8_STAGE(PG8_SB(1, 1), cB + hstep + kstep, voffB);
        PG8_WAIT_V(6); PG8_BAR;
    } else {
        PG8_STAGE(PG8_SB(0, 0), cB, voffB); PG8_STAGE(PG8_SA(0, 0), cA, voffA); PG8_STAGE(PG8_SB(0, 1), cB + hstep, voffB); PG8_STAGE(PG8_SA(0, 1), cA + hstep, voffA);
        if (wr == 1) PG8_BAR;
        PG8_WAIT_V(4); PG8_BAR;
        PG8_STAGE(PG8_SB(1, 0), cB + kstep, voffB); PG8_STAGE(PG8_SA(1, 0), cA + kstep, voffA); PG8_STAGE(PG8_SB(1, 1), cB + hstep + kstep, voffB);
        PG8_WAIT_V(6); PG8_BAR;
    }
    for (;;) {
        const bool has_next = S.next(ui + 1, nxt);
        const char* nA = has_next ? (const char*)g.A + (size_t)nxt.pm * tstep : cA; const char* nB = has_next ? (const char*)g.Bt + (size_t)nxt.pn * tstep : cB;
        for (int t = 0; t < nt; t += 2) {
            const bool last = (t == nt - 2);
            const char* a1 = cA + (size_t)(t + 1) * kstep;
            const char* a2 = last ? nA : cA + (size_t)(t + 2) * kstep; const char* b2 = last ? nB : cB + (size_t)(t + 2) * kstep;
            const char* a3 = a2 + kstep; const char* b3 = b2 + kstep;
            if (last && has_next) S.a_ready(nxt);
            if constexpr (SP2) {
            PG8_LDB(B0, 0, 0); PG8_LDB(B1, 0, 1); PG8_SCHED; PG8_LDA(At, 0, 0); PG8_STAGE(PG8_SA(1, 1), a1 + hstep, voffA);
            PG8_WAIT_V(8); PG8_WAIT_L(0); PG8_BAR; PG8_MMA(0, 0, At, B0); PG8_MMA(0, 1, At, B1); PG8_BAR; PG8_SCHED;
            PG8_LDA(At, 0, 1); PG8_STAGE(PG8_SB(0, 0), b2, voffB); PG8_STAGE(PG8_SB(0, 1), b2 + hstep, voffB); PG8_STAGE(PG8_SA(0, 0), a2, voffA);
            PG8_WAIT_V(8); PG8_WAIT_L(0); PG8_BAR; PG8_MMA(1, 0, At, B0); PG8_MMA(1, 1, At, B1); PG8_BAR; PG8_SCHED;
            PG8_LDB(B0, 1, 0); PG8_LDB(B1, 1, 1); PG8_SCHED; PG8_LDA(At, 1, 0); PG8_STAGE(PG8_SA(0, 1), a2 + hstep, voffA);
            PG8_WAIT_V(8); PG8_WAIT_L(0); PG8_BAR; PG8_MMA(0, 0, At, B0); PG8_MMA(0, 1, At, B1); PG8_BAR; PG8_SCHED;
            PG8_LDA(At, 1, 1); PG8_STAGE(PG8_SB(1, 0), b3, voffB); PG8_STAGE(PG8_SB(1, 1), b3 + hstep, voffB); PG8_STAGE(PG8_SA(1, 0), a3, voffA);
            PG8_WAIT_V(8); PG8_WAIT_L(0); PG8_BAR; PG8_MMA(1, 0, At, B0); PG8_MMA(1, 1, At, B1); PG8_BAR; PG8_SCHED;
            } else {
            PG8_LDB(B0, 0, 0); PG8_SCHED; PG8_LDA(At, 0, 0); PG8_STAGE(PG8_SA(1, 1), a1 + hstep, voffA);
            PG8_WAIT_L(8); PG8_BAR; PG8_WAIT_L(0); PG8_MMA(0, 0, At, B0); PG8_BAR; PG8_SCHED;
            PG8_LDB(B1, 0, 1); PG8_STAGE(PG8_SB(0, 0), b2, voffB);
            PG8_BAR; PG8_WAIT_L(0); PG8_MMA(0, 1, At, B1); PG8_BAR;
            PG8_LDA(At, 0, 1); PG8_STAGE(PG8_SA(0, 0), a2, voffA);
            PG8_BAR; PG8_WAIT_L(0); PG8_MMA(1, 0, At, B0); PG8_BAR; PG8_SCHED;
            PG8_STAGE(PG8_SB(0, 1), b2 + hstep, voffB);
            PG8_WAIT_V(6); PG8_BAR; PG8_MMA(1, 1, At, B1); PG8_BAR;
            PG8_LDB(B0, 1, 0); PG8_SCHED; PG8_LDA(At, 1, 0); PG8_STAGE(PG8_SA(0, 1), a2 + hstep, voffA);
            PG8_WAIT_L(8); PG8_BAR; PG8_WAIT_L(0); PG8_MMA(0, 0, At, B0); PG8_BAR; PG8_SCHED;
            PG8_LDB(B1, 1, 1); PG8_STAGE(PG8_SB(1, 0), b3, voffB);
            PG8_BAR; PG8_WAIT_L(0); PG8_MMA(0, 1, At, B1); PG8_BAR;
            PG8_LDA(At, 1, 1); PG8_STAGE(PG8_SA(1, 0), a3, voffA);
            PG8_BAR; PG8_WAIT_L(0); PG8_MMA(1, 0, At, B0); PG8_BAR; PG8_SCHED;
            PG8_STAGE(PG8_SB(1, 1), b3 + hstep, voffB);
            PG8_WAIT_V(6); PG8_BAR; PG8_MMA(1, 1, At, B1); PG8_BAR;
            }
        }
        if constexpr (ALIGN_EPI) { if (wr == 0) PG8_BAR; }
        if constexpr (!Epi::AFTER_DRAIN) { E(acc, cur, wr, wc, fr, fq); S.done(cur); }
        if (!has_next) break;
#pragma unroll
        for (int a = 0; a < 2; ++a)
#pragma unroll
            for (int b = 0; b < 2; ++b)
#pragma unroll
                for (int m = 0; m < 4; ++m)
#pragma unroll
                    for (int n = 0; n < 2; ++n) acc[a][b][m][n] = (f32x4){0.f, 0.f, 0.f, 0.f};
        cur = nxt; cA = nA; cB = nB; ++ui;
        if constexpr (ALIGN_EPI) { if (wr == 1) PG8_BAR; }
    }
    PG8_WAIT_V(0);
    if constexpr (!ALIGN_EPI) { if (wr == 0) PG8_BAR; }
    PG8_BAR;
    if constexpr (Epi::AFTER_DRAIN) { E.fused(acc, cur, wr, wc, fr, fq, lds, wid, lane); S.done(cur); }
#undef PG8_SA
#undef PG8_SB
#undef PG8_STAGE
#undef PG8_LDA
#undef PG8_LDB
#undef PG8_MMA
#undef PG8_WAIT_V
#undef PG8_WAIT_L
#undef PG8_BAR
#undef PG8_SCHED
}
}

constexpr int BATCH = 4, SEQ = 8192, DM = 1024, M = BATCH * SEQ, NIN = 2816;
constexpr int C_AQ = 0, C_AK = 512, C_AV = 640, C_AZ = 768, C_RQ = 1280, C_RK = 1536, C_RV = 1792, C_RZ = 2304;
constexpr float RMS_EPS = 1e-6f, GN_EPS = 1e-6f;
constexpr size_t MiB = 1u << 20;
constexpr size_t WS_RS = 0;
constexpr size_t WS_WIN = 2 * MiB;
constexpr size_t WS_WOUT = 8 * MiB;
constexpr size_t WS_CS = 10 * MiB;
constexpr size_t WS_XN = 16 * MiB;
constexpr size_t WS_PROJ = 80 * MiB;
constexpr size_t WS_KV = 256 * MiB;
constexpr size_t WS_PREV = 288 * MiB;
constexpr size_t WS_MIX = 304 * MiB;
constexpr size_t WS_END = 368 * MiB;
constexpr int LDS_BYTES = 147456;
constexpr int NWAVES = 8;

#define LAS __attribute__((address_space(3)))
typedef unsigned short bf16;
typedef short bf16x8 __attribute__((ext_vector_type(8)));
typedef short s16x4 __attribute__((ext_vector_type(4)));
typedef float f32x4 __attribute__((ext_vector_type(4)));
typedef float f32x2 __attribute__((ext_vector_type(2)));
typedef float f32x16 __attribute__((ext_vector_type(16)));
typedef unsigned u32x4 __attribute__((ext_vector_type(4)));
typedef unsigned u32x2 __attribute__((ext_vector_type(2)));
#define DI __device__ __forceinline__
#define MFMA32(a, b, c) __builtin_amdgcn_mfma_f32_32x32x16_bf16((a), (b), (c), 0, 0, 0)

DI unsigned f2bf(float f) { unsigned u = __builtin_bit_cast(unsigned, f); return (u + 0x7fffu + ((u >> 16) & 1u)) >> 16; }
DI unsigned pk2(float lo, float hi) { return f2bf(lo) | (f2bf(hi) << 16); }
DI float bflo(unsigned w) { return __builtin_bit_cast(float, w << 16); }
DI float bfhi(unsigned w) { return __builtin_bit_cast(float, w & 0xffff0000u); }
DI int crow(int reg, int h) { return (reg & 3) + 8 * (reg >> 2) + 4 * h; }
DI float wave_sum(float v) {
#pragma unroll
    for (int o = 1; o < 64; o <<= 1) v += __shfl_xor(v, o);
    return v;
}
DI float silu(float z) { return z / (1.0f + __expf(-z)); }
DI float lg2gamma(int h) { return log2f(1.0f - exp2f(-5.0f - (float)h)); }
DI f32x16 zero16() { f32x16 z;
#pragma unroll
    for (int i = 0; i < 16; ++i) z[i] = 0.f;
    return z; }
DI bf16x8 pack8(const f32x16& x, int s) {
    u32x4 p; p.x = pk2(x[8 * s + 0], x[8 * s + 1]); p.y = pk2(x[8 * s + 2], x[8 * s + 3]); p.z = pk2(x[8 * s + 4], x[8 * s + 5]); p.w = pk2(x[8 * s + 6], x[8 * s + 7]);
    return __builtin_bit_cast(bf16x8, p);
}

struct Args { const float* x; const float* norm_g; const float* w_in; const float* sinks; const float* gn_g; const float* w_out; const float* final_g; float* out; unsigned char* ws; };

DI void p0_transpose_item(const float* W, int K, int N, bf16* WT, LAS float* scr, int item, int lane) {
    const int nblk = N / 32, kb = item / nblk, nb = item % nblk, k0 = 64 * kb, n0 = 32 * nb;
#pragma unroll 8
    for (int i = 0; i < 32; ++i) { const int kk = 2 * i + (lane >> 5); scr[kk * 33 + (lane & 31)] = W[(size_t)(k0 + kk) * N + n0 + (lane & 31)]; }
    asm volatile("s_waitcnt lgkmcnt(0)" ::: "memory");
    const int c = lane & 7;
#pragma unroll
    for (int j = 0; j < 4; ++j) { const int n = (lane >> 3) + 8 * j; const LAS float* s = scr + (8 * c) * 33 + n;
        u32x4 o; o.x = pk2(s[0 * 33], s[1 * 33]); o.y = pk2(s[2 * 33], s[3 * 33]); o.z = pk2(s[4 * 33], s[5 * 33]); o.w = pk2(s[6 * 33], s[7 * 33]);
        *(u32x4*)(WT + (size_t)(n0 + n) * K + k0 + 8 * c) = o; }
    asm volatile("s_waitcnt lgkmcnt(0)" ::: "memory");
}
DI void p0_prologue(const Args& a, LAS unsigned char* lds, int tid, int wave, int lane, int G) {
    unsigned char* ws = a.ws;
    LAS float* scr = (LAS float*)(lds + wave * 16384);
    const int gw = blockIdx.x * NWAVES + wave, NGW = G * NWAVES;
    constexpr int I_IN = (DM / 64) * (NIN / 32), I_OUT = (DM / 64) * (DM / 32);
    for (int it = gw; it < I_IN + I_OUT; it += NGW) {
        if (it < I_IN) p0_transpose_item(a.w_in, DM, NIN, (bf16*)(ws + WS_WIN), scr, it, lane);
        else p0_transpose_item(a.w_out, DM, DM, (bf16*)(ws + WS_WOUT), scr, it - I_IN, lane);
    }
    bf16* XN = (bf16*)(ws + WS_XN);
    f32x4 gv[4];
#pragma unroll
    for (int j = 0; j < 4; ++j) gv[j] = ((const f32x4*)a.norm_g)[lane + 64 * j];
    for (int m = gw; m < M; m += NGW) {
        const f32x4* xr = (const f32x4*)(a.x + (size_t)m * DM) + lane;
        f32x4 v[4]; float s = 0.f;
#pragma unroll
        for (int j = 0; j < 4; ++j) { v[j] = xr[64 * j]; s += (v[j].x * v[j].x + v[j].y * v[j].y) + (v[j].z * v[j].z + v[j].w * v[j].w); }
        const float rstd = 1.0f / sqrtf(wave_sum(s) * (1.0f / DM) + RMS_EPS);
        u32x2* o8 = (u32x2*)(XN + (size_t)m * DM) + lane;
#pragma unroll
        for (int j = 0; j < 4; ++j) { u32x2 w; w.x = pk2(v[j].x * rstd * gv[j].x, v[j].y * rstd * gv[j].y); w.y = pk2(v[j].z * rstd * gv[j].z, v[j].w * rstd * gv[j].w); o8[64 * j] = w; }
    }
    f32x2* CS = (f32x2*)(ws + WS_CS);
    for (int idx = blockIdx.x * 512 + tid; idx < SEQ * 32; idx += G * 512) {
        const int pos = idx >> 5, j = idx & 31;
        const float theta = (float)exp(-((double)j / 31.0) * 9.210340371976184);
        const float ang = (float)pos * theta;
        const double xx = (double)ang, kq = rint(xx * 0.6366197723675814);
        double rr = fma(-kq, 1.5707963267948966, xx); rr = fma(-kq, 6.123233995736766e-17, rr);
        const int q = (int)kq & 3; const double r2 = rr * rr;
        const double sn = rr * (1.0 + r2 * (-1.0 / 6.0 + r2 * (1.0 / 120.0 + r2 * (-1.0 / 5040.0 + r2 * (1.0 / 362880.0 + r2 * (-1.0 / 39916800.0))))));
        const double cn = 1.0 + r2 * (-0.5 + r2 * (1.0 / 24.0 + r2 * (-1.0 / 720.0 + r2 * (1.0 / 40320.0 + r2 * (-1.0 / 3628800.0 + r2 * (1.0 / 479001600.0))))));
        const double cc = (q == 0) ? cn : (q == 1) ? -sn : (q == 2) ? -cn : sn;
        const double sv = (q == 0) ? sn : (q == 1) ? cn : (q == 2) ? -sn : -cn;
        CS[idx] = (f32x2){(float)cc, (float)sv};
    }
}

DI void attn_unit(const Args& a, LAS unsigned char* lds, int u, int tid, int wave, int lane) {
    asm volatile("" : "+v"(tid), "+v"(lane));
    const bf16* PROJ = (const bf16*)(a.ws + WS_PROJ); bf16* MIX = (bf16*)(a.ws + WS_MIX);
    const int b = u >> 7, n = (u >> 1) & 63, kvh = u & 1;
    const size_t t0 = (size_t)b * SEQ + (size_t)n * 128;
    LAS unsigned char* Ks = lds;
    LAS unsigned char* Vt = lds + 36864;
#pragma unroll
    for (int i = 0; i < 4; ++i) {
        const int c = tid + i * 512, row = c >> 3, ch = c & 7;
        u32x4 kv = (u32x4){0u, 0u, 0u, 0u}, vv = (u32x4){0u, 0u, 0u, 0u};
        if (n > 0 || row >= 128) {
            const bf16* src = PROJ + (t0 + (size_t)row - 128) * NIN;
            kv = *(const u32x4*)(src + C_AK + kvh * 64 + ch * 8);
            vv = *(const u32x4*)(src + C_AV + kvh * 64 + ch * 8);
        }
        *(LAS u32x4*)(Ks + row * 144 + ch * 16) = kv;
#pragma unroll
        for (int j = 0; j < 8; ++j) { const unsigned w = vv[j >> 1]; *(LAS unsigned short*)(Vt + (ch * 8 + j) * 520 + row * 2) = (unsigned short)((j & 1) ? (w >> 16) : (w & 0xffffu)); }
    }
    __syncthreads();
    const int g = wave >> 1, head = kvh * 4 + g, r = lane & 31, h = lane >> 5;
    const float sink = a.sinks[head];
#pragma unroll 1
    for (int tt = 0; tt < 2; ++tt) {
        const int rg = 2 * (wave & 1) + tt;
        const size_t tok = t0 + 32 * rg + r;
        const bf16* qrow = PROJ + tok * NIN + C_AQ + head * 64 + 8 * h;
        bf16x8 qf[4];
#pragma unroll
        for (int s = 0; s < 4; ++s) qf[s] = *(const bf16x8*)(qrow + 16 * s);
        f32x16 st[5];
#pragma unroll
        for (int kt = 0; kt < 5; ++kt) {
            st[kt] = zero16();
#pragma unroll
            for (int s = 0; s < 4; ++s) { const bf16x8 ka = *(const LAS bf16x8*)(Ks + (32 * (rg + kt) + r) * 144 + (16 * s + 8 * h) * 2); st[kt] = MFMA32(ka, qf[s], st[kt]); }
        }
        float mx = sink;
#pragma unroll
        for (int kt = 0; kt < 5; ++kt)
#pragma unroll
            for (int i = 0; i < 16; ++i) {
                const int cr = crow(i, h); bool valid = true;
                if (kt == 0) valid = cr > r;
                if (kt == 4) valid = cr <= r;
                if (n == 0) valid = valid && (32 * (rg + kt) + cr >= 128);
                const float t = valid ? st[kt][i] * 0.125f : -1e30f; st[kt][i] = t; mx = fmaxf(mx, t);
            }
        mx = fmaxf(mx, __shfl_xor(mx, 32));
        float l = 0.f;
#pragma unroll
        for (int kt = 0; kt < 5; ++kt)
#pragma unroll
            for (int i = 0; i < 16; ++i) { const float p = __expf(st[kt][i] - mx); st[kt][i] = p; l += p; }
        l += __shfl_xor(l, 32); l += __expf(sink - mx);
        f32x16 o[2]; o[0] = zero16(); o[1] = zero16();
#pragma unroll
        for (int kt = 0; kt < 5; ++kt)
#pragma unroll
            for (int s2 = 0; s2 < 2; ++s2) {
                const bf16x8 pb = pack8(st[kt], s2);
#pragma unroll
                for (int dt = 0; dt < 2; ++dt) {
                    const LAS unsigned char* vp = Vt + (32 * dt + r) * 520 + (32 * (rg + kt) + 16 * s2 + 4 * h) * 2;
                    const s16x4 lo = *(const LAS s16x4*)vp, hi = *(const LAS s16x4*)(vp + 16);
                    const bf16x8 va = __builtin_shufflevector(lo, hi, 0, 1, 2, 3, 4, 5, 6, 7);
                    o[dt] = MFMA32(va, pb, o[dt]);
                }
            }
        const float inv = 1.0f / l;
#pragma unroll
        for (int dt = 0; dt < 2; ++dt)
#pragma unroll
            for (int gq = 0; gq < 4; ++gq) {
                const int d = 32 * dt + 8 * gq + 4 * h;
                const u32x2 zz = *(const u32x2*)(PROJ + tok * NIN + C_AZ + head * 64 + d);
                u32x2 w; w.x = pk2(o[dt][4 * gq + 0] * inv * silu(bflo(zz.x)), o[dt][4 * gq + 1] * inv * silu(bfhi(zz.x)));
                w.y = pk2(o[dt][4 * gq + 2] * inv * silu(bflo(zz.y)), o[dt][4 * gq + 3] * inv * silu(bfhi(zz.y)));
                *(u32x2*)(MIX + tok * DM + head * 64 + d) = w;
            }
    }
    __syncthreads();
}

DI void rot8(const u32x4 w, const f32x4 cs0, const f32x4 cs1, float sc, float (&o)[8]) {
    const float a0 = bflo(w.x), b0 = bfhi(w.x), a1 = bflo(w.y), b1 = bfhi(w.y), a2 = bflo(w.z), b2 = bfhi(w.z), a3 = bflo(w.w), b3 = bfhi(w.w);
    o[0] = (a0 * cs0.x - b0 * cs0.y) * sc; o[1] = (a0 * cs0.y + b0 * cs0.x) * sc;
    o[2] = (a1 * cs0.z - b1 * cs0.w) * sc; o[3] = (a1 * cs0.w + b1 * cs0.z) * sc;
    o[4] = (a2 * cs1.x - b2 * cs1.y) * sc; o[5] = (a2 * cs1.y + b2 * cs1.x) * sc;
    o[6] = (a3 * cs1.z - b3 * cs1.w) * sc; o[7] = (a3 * cs1.w + b3 * cs1.z) * sc;
}

DI void kvchunk_unit(const Args& a, LAS unsigned char* lds, int v, int tid, int wave, int lane) {
    asm volatile("" : "+v"(tid), "+v"(lane));
    const bf16* PROJ = (const bf16*)(a.ws + WS_PROJ); const float* CS = (const float*)(a.ws + WS_CS); float* KV = (float*)(a.ws + WS_KV);
    const int b = v >> 8, n = (v >> 2) & 63, hh = v & 3;
    const size_t t0 = (size_t)b * SEQ + (size_t)n * 128;
    const float l2g = lg2gamma(hh);
    LAS unsigned char* Kt = lds;
    LAS unsigned char* Vt = lds + 17408;
#pragma unroll
    for (int i = 0; i < 2; ++i) {
        const int c = tid + i * 512, m = c >> 3, ch = c & 7;
        const u32x4 w = *(const u32x4*)(PROJ + (t0 + m) * NIN + C_RK + hh * 64 + ch * 8);
        const f32x4* cp = (const f32x4*)(CS + ((size_t)(n * 128 + m) * 32 + ch * 4) * 2);
        float o[8]; rot8(w, cp[0], cp[1], 0.125f * exp2f((float)(127 - m) * l2g), o);
#pragma unroll
        for (int j = 0; j < 8; ++j) *(LAS unsigned short*)(Kt + (ch * 8 + j) * 272 + m * 2) = (unsigned short)f2bf(o[j]);
    }
#pragma unroll
    for (int i = 0; i < 4; ++i) {
        const int c = tid + i * 512, m = c >> 4, ch = c & 15;
        const u32x4 w = *(const u32x4*)(PROJ + (t0 + m) * NIN + C_RV + hh * 128 + ch * 8);
#pragma unroll
        for (int j = 0; j < 8; ++j) { const unsigned x = w[j >> 1]; *(LAS unsigned short*)(Vt + (ch * 8 + j) * 272 + m * 2) = (unsigned short)((j & 1) ? (x >> 16) : (x & 0xffffu)); }
    }
    __syncthreads();
    const int et = wave >> 1, dt = wave & 1, r = lane & 31, h = lane >> 5;
    f32x16 acc = zero16();
#pragma unroll
    for (int s = 0; s < 8; ++s) {
        const bf16x8 va = *(const LAS bf16x8*)(Vt + (32 * et + r) * 272 + (16 * s + 8 * h) * 2);
        const bf16x8 kb = *(const LAS bf16x8*)(Kt + (32 * dt + r) * 272 + (16 * s + 8 * h) * 2);
        acc = MFMA32(va, kb, acc);
    }
    float* dst = KV + (size_t)v * 8192 + 32 * dt + r;
#pragma unroll
    for (int i = 0; i < 16; ++i) dst[(32 * et + crow(i, h)) * 64] = acc[i];
    __syncthreads();
}

DI void scan_phase(const Args& a, int tid, int G) {
    const float* KV = (const float*)(a.ws + WS_KV); bf16* PREV = (bf16*)(a.ws + WS_PREV);
    for (int idx = blockIdx.x * 512 + tid; idx < BATCH * 4 * 8192; idx += G * 512) {
        const int ed = idx & 8191, hh = (idx >> 13) & 3, b = idx >> 15;
        const float cd = exp2f(128.0f * lg2gamma(hh));
        float state = 0.f;
        const size_t base = ((size_t)(b * 64) * 4 + hh) * 8192 + ed;
#pragma unroll 1
        for (int n0 = 0; n0 < 64; n0 += 8) {
            float kv[8];
#pragma unroll
            for (int j = 0; j < 8; ++j) kv[j] = KV[base + (size_t)(n0 + j) * 4 * 8192];
#pragma unroll
            for (int j = 0; j < 8; ++j) { PREV[base + (size_t)(n0 + j) * 4 * 8192] = (bf16)f2bf(state); state = state * cd + kv[j]; }
        }
    }
}

DI void retout_unit(const Args& a, LAS unsigned char* lds, int w2, int tid, int wave, int lane) {
    asm volatile("" : "+v"(tid), "+v"(lane));
    const bf16* PROJ = (const bf16*)(a.ws + WS_PROJ); const float* CS = (const float*)(a.ws + WS_CS); const bf16* PREV = (const bf16*)(a.ws + WS_PREV); bf16* MIX = (bf16*)(a.ws + WS_MIX);
    const int b = w2 >> 7, n = (w2 >> 1) & 63, hs = wave >> 2, hh = 2 * (w2 & 1) + hs;
    const size_t t0 = (size_t)b * SEQ + (size_t)n * 128;
    const int unit = (b * 64 + n) * 4 + hh;
    const float l2g = lg2gamma(hh);
    LAS unsigned char* Ks = lds + hs * 52224;
    LAS unsigned char* Vt = Ks + 18432;
    const int tid2 = tid & 255;
#pragma unroll
    for (int i = 0; i < 4; ++i) {
        const int c = tid2 + i * 256, m = c >> 3, ch = c & 7;
        const u32x4 w = *(const u32x4*)(PROJ + (t0 + m) * NIN + C_RK + hh * 64 + ch * 8);
        const f32x4* cp = (const f32x4*)(CS + ((size_t)(n * 128 + m) * 32 + ch * 4) * 2);
        float o[8]; rot8(w, cp[0], cp[1], 0.125f, o);
        u32x4 p; p.x = pk2(o[0], o[1]); p.y = pk2(o[2], o[3]); p.z = pk2(o[4], o[5]); p.w = pk2(o[6], o[7]);
        *(LAS u32x4*)(Ks + m * 144 + ch * 16) = p;
    }
#pragma unroll
    for (int i = 0; i < 8; ++i) {
        const int c = tid2 + i * 256, m = c >> 4, ch = c & 15;
        const u32x4 w = *(const u32x4*)(PROJ + (t0 + m) * NIN + C_RV + hh * 128 + ch * 8);
#pragma unroll
        for (int j = 0; j < 8; ++j) { const unsigned x = w[j >> 1]; *(LAS unsigned short*)(Vt + (ch * 8 + j) * 264 + m * 2) = (unsigned short)((j & 1) ? (x >> 16) : (x & 0xffffu)); }
    }
    __syncthreads();
    const int ct = wave & 3, r = lane & 31, h = lane >> 5, cl = 32 * ct + r;
    const size_t tok = t0 + cl;
    bf16x8 qf[4];
#pragma unroll
    for (int s = 0; s < 4; ++s) {
        const u32x4 w = *(const u32x4*)(PROJ + tok * NIN + C_RQ + hh * 64 + 16 * s + 8 * h);
        const f32x4* cp = (const f32x4*)(CS + ((size_t)(n * 128 + cl) * 32 + 8 * s + 4 * h) * 2);
        float o[8]; rot8(w, cp[0], cp[1], 1.0f, o);
        u32x4 p; p.x = pk2(o[0], o[1]); p.y = pk2(o[2], o[3]); p.z = pk2(o[4], o[5]); p.w = pk2(o[6], o[7]);
        qf[s] = __builtin_bit_cast(bf16x8, p);
    }
    f32x16 o[4];
    const bf16* pv = PREV + (size_t)unit * 8192;
#pragma unroll
    for (int et = 0; et < 4; ++et) {
        o[et] = zero16();
#pragma unroll
        for (int s = 0; s < 4; ++s) { const bf16x8 pa = *(const bf16x8*)(pv + (32 * et + r) * 64 + 16 * s + 8 * h); o[et] = MFMA32(pa, qf[s], o[et]); }
    }
    const float qdec = exp2f((float)(cl + 1) * l2g);
#pragma unroll
    for (int et = 0; et < 4; ++et)
#pragma unroll
        for (int i = 0; i < 16; ++i) o[et][i] *= qdec;
#pragma unroll
    for (int mt = 0; mt < 4; ++mt) {
        if (mt <= ct) {
            f32x16 st = zero16();
#pragma unroll
            for (int s = 0; s < 4; ++s) { const bf16x8 ka = *(const LAS bf16x8*)(Ks + (32 * mt + r) * 144 + (16 * s + 8 * h) * 2); st = MFMA32(ka, qf[s], st); }
#pragma unroll
            for (int i = 0; i < 16; ++i) { const int dl = cl - (32 * mt + crow(i, h)); st[i] = (dl >= 0) ? st[i] * exp2f((float)dl * l2g) : 0.f; }
#pragma unroll
            for (int s2 = 0; s2 < 2; ++s2) {
                const bf16x8 pb = pack8(st, s2);
#pragma unroll
                for (int et = 0; et < 4; ++et) {
                    const LAS unsigned char* vp = Vt + (32 * et + r) * 264 + (32 * mt + 16 * s2 + 4 * h) * 2;
                    const s16x4 lo = *(const LAS s16x4*)vp, hi = *(const LAS s16x4*)(vp + 16);
                    const bf16x8 va = __builtin_shufflevector(lo, hi, 0, 1, 2, 3, 4, 5, 6, 7);
                    o[et] = MFMA32(va, pb, o[et]);
                }
            }
        }
    }
    float sm = 0.f;
#pragma unroll
    for (int et = 0; et < 4; ++et)
#pragma unroll
        for (int i = 0; i < 16; ++i) sm += o[et][i];
    sm += __shfl_xor(sm, 32);
    const float mu = sm * (1.0f / 128.0f);
    float vs = 0.f;
#pragma unroll
    for (int et = 0; et < 4; ++et)
#pragma unroll
        for (int i = 0; i < 16; ++i) { const float d = o[et][i] - mu; vs += d * d; }
    vs += __shfl_xor(vs, 32);
    const float rstd = 1.0f / sqrtf(vs * (1.0f / 128.0f) + GN_EPS);
#pragma unroll
    for (int et = 0; et < 4; ++et)
#pragma unroll
        for (int gq = 0; gq < 4; ++gq) {
            const int e = 32 * et + 8 * gq + 4 * h;
            const u32x2 zz = *(const u32x2*)(PROJ + tok * NIN + C_RZ + hh * 128 + e);
            const f32x4 gn = *(const f32x4*)(a.gn_g + hh * 128 + e);
            u32x2 w; w.x = pk2((o[et][4 * gq + 0] - mu) * rstd * gn.x * silu(bflo(zz.x)), (o[et][4 * gq + 1] - mu) * rstd * gn.y * silu(bfhi(zz.x)));
            w.y = pk2((o[et][4 * gq + 2] - mu) * rstd * gn.z * silu(bflo(zz.y)), (o[et][4 * gq + 3] - mu) * rstd * gn.w * silu(bfhi(zz.y)));
            *(u32x2*)(MIX + tok * DM + 512 + hh * 128 + e) = w;
        }
    __syncthreads();
}

DI void final_norm(const Args& a, int wave, int lane, int G) {
    const float* RS = (const float*)(a.ws + WS_RS);
    const int gw = blockIdx.x * NWAVES + wave, NGW = G * NWAVES;
    f32x4 gv[4];
#pragma unroll
    for (int j = 0; j < 4; ++j) gv[j] = ((const f32x4*)a.final_g)[lane + 64 * j];
    for (int m = gw; m < M; m += NGW) {
        float s = (lane < 16) ? RS[(size_t)m * 16 + lane] : 0.f;
        const float rstd = 1.0f / sqrtf(wave_sum(s) * (1.0f / DM) + RMS_EPS);
        f32x4* yr = (f32x4*)(a.out + (size_t)m * DM) + lane;
#pragma unroll
        for (int j = 0; j < 4; ++j) { f32x4 v = yr[64 * j]; v = v * rstd * gv[j]; yr[64 * j] = v; }
    }
}

__global__ void __launch_bounds__(NWAVES * 64, 2) hymba_fwd(Args a) {
    extern __shared__ __attribute__((aligned(16))) unsigned char lds_raw[];
    LAS unsigned char* lds = (LAS unsigned char*)lds_raw;
    cg::grid_group grid = cg::this_grid();
    const int tid = threadIdx.x, lane = tid & 63, wave = __builtin_amdgcn_readfirstlane(tid >> 6), G = gridDim.x;
    unsigned char* ws = a.ws;

    p0_prologue(a, lds, tid, wave, lane, G);
    grid.sync();
    {
        pg8::Gemm g{(const pg8::bf16_t*)(ws + WS_XN), (const pg8::bf16_t*)(ws + WS_WIN), M, NIN, DM}; pg8::StaticOrder S; S.init(M, NIN, G, (int)blockIdx.x);
        pg8::EpiBf16<0> E{(pg8::bf16_t*)(ws + WS_PROJ), NIN, nullptr, 0, 0, 1.f};
        pg8::gemm_phase<pg8::EpiBf16<0>, pg8::StaticOrder, true, true>(lds, g, S, E);
    }
    grid.sync();
    for (int u = blockIdx.x; u < BATCH * 64 * 2; u += G) attn_unit(a, lds, u, tid, wave, lane);
    for (int v = blockIdx.x; v < BATCH * 64 * 4; v += G) kvchunk_unit(a, lds, v, tid, wave, lane);
    grid.sync();
    scan_phase(a, tid, G);
    grid.sync();
    for (int w2 = blockIdx.x; w2 < BATCH * 64 * 2; w2 += G) retout_unit(a, lds, w2, tid, wave, lane);
    grid.sync();
    {
        pg8::Gemm g{(const pg8::bf16_t*)(ws + WS_MIX), (const pg8::bf16_t*)(ws + WS_WOUT), M, DM, DM}; pg8::StaticOrder S; S.init(M, DM, G, (int)blockIdx.x);
        pg8::EpiResid E{a.x, a.out, (float*)(ws + WS_RS), DM};
        pg8::gemm_phase<pg8::EpiResid, pg8::StaticOrder, true, true>(lds, g, S, E);
    }
    grid.sync();
    final_norm(a, wave, lane, G);
}

extern "C" void kernel_launch(void* const* d_in, const int* in_sizes, int n_in, void* d_out, int out_size, void* d_ws, size_t ws_size, hipStream_t stream) {
    static int grid = 0;
    if (grid == 0) {
        if (n_in != 7 || in_sizes[0] != M * DM || out_size != M * DM || ws_size < WS_END) { fprintf(stderr, "kernel_launch: unexpected shapes (n_in %d, in0 %d, out %d, ws %zu)\n", n_in, n_in > 0 ? in_sizes[0] : -1, out_size, ws_size); grid = -1; return; }
        int dev = 0, cus = 0, per_cu = 0;
        if (hipGetDevice(&dev) != hipSuccess || hipDeviceGetAttribute(&cus, hipDeviceAttributeMultiprocessorCount, dev) != hipSuccess) { grid = -1; return; }
        if (hipFuncSetAttribute((const void*)hymba_fwd, hipFuncAttributeMaxDynamicSharedMemorySize, LDS_BYTES) != hipSuccess) { fprintf(stderr, "kernel_launch: hipFuncSetAttribute failed\n"); grid = -1; return; }
        if (hipOccupancyMaxActiveBlocksPerMultiprocessor(&per_cu, (const void*)hymba_fwd, NWAVES * 64, LDS_BYTES) != hipSuccess || per_cu < 1) { fprintf(stderr, "kernel_launch: occupancy query says %d blocks per CU\n", per_cu); per_cu = 1; }
        (void)hipGetLastError();
        grid = cus;
    }
    if (grid < 0) return;
    Args a{};
    a.x = (const float*)d_in[0]; a.norm_g = (const float*)d_in[1]; a.w_in = (const float*)d_in[2]; a.sinks = (const float*)d_in[3];
    a.gn_g = (const float*)d_in[4]; a.w_out = (const float*)d_in[5]; a.final_g = (const float*)d_in[6]; a.out = (float*)d_out; a.ws = (unsigned char*)d_ws;
    void* args[] = {&a};
    const hipError_t e = hipLaunchCooperativeKernel((const void*)hymba_fwd, dim3(grid), dim3(NWAVES * 64), args, LDS_BYTES, stream);
    if (e != hipSuccess) fprintf(stderr, "kernel_launch: cooperative launch failed: %s (grid %d)\n", hipGetErrorString(e), grid);
}
```
